# Optimizing an MI355X kernel written in HIP

```python
import math
import jax, jax.numpy as jnp
from jax import lax
import numpy as np

D_MODEL = 1024
BATCH = 2
SEQ = 8192
DEPTH = 2

CTX_LEN = 256
GRID_W = 64
N_MOD = 9
D_MIX = D_MODEL
W_A = D_MIX // 2
W_B = D_MIX // 4
W_C = D_MIX - W_A - W_B
D_IN = 2 * W_A + W_B + 3 * W_C
RG_HEADS = 8
RG_HD = W_A // RG_HEADS
RG_CONV = 4
RG_C = 8.0
POOL_WINDOWS = (2, 4, 8, 16)
POOL_GROUPS = len(POOL_WINDOWS)
POOL_GW = W_B // POOL_GROUPS
HY_ORDER = 2
HY_SHORT = 3
HY_BANDS = 16
HY_EMB = 2 * HY_BANDS + 1
HY_FH = 64
HY_TARGET = 1e-2
HY_FAST = 0.3
HY_SLOW = 1.5
D_FF = 256 * math.ceil(8 * D_MODEL / 3 / 256)
EPS = 1e-6

kernel_name = 'hybrid_lru_pool_hyena_prefix_dit'


def rmsnorm(x, g):
    xf = x.astype(jnp.float32)
    y = xf * lax.rsqrt(jnp.mean(xf * xf, axis=-1, keepdims=True) + EPS)
    return (y * g.astype(jnp.float32)).astype(x.dtype)


def adanorm(x, g, shift, scale):
    return rmsnorm(x, g) * (1 + scale) + shift


def swiglu(h, w_in, w_out):
    gate, up = jnp.split(h @ w_in, 2, axis=-1)
    return (jax.nn.silu(gate) * up) @ w_out


def dwconv(u, w, b, pad_left):
    k_w = w.shape[0]
    n = u.shape[1]
    up = jnp.pad(u, ((0, 0), (pad_left, k_w - 1 - pad_left), (0, 0)))
    out = b + w[0] * up[:, 0:n]
    for k in range(1, k_w):
        out = out + w[k] * up[:, k:k + n]
    return out


def _affine_combine(e1, e2):
    a1, b1 = e1
    a2, b2 = e2
    return a1 * a2, a2 * b1 + b2


def rglru_coeffs(u, w_g, b_g, lam):
    bn, n, w = u.shape
    pre = jnp.einsum('blhc,ghcd->gblhd', u.reshape(bn, n, RG_HEADS, RG_HD), w_g.astype(jnp.float32))
    pre = pre.reshape(2, bn, n, w) + b_g.astype(jnp.float32)[:, None, None, :]
    r = jax.nn.sigmoid(pre[0])
    i = jax.nn.sigmoid(pre[1])
    log_a = -RG_C * r * jax.nn.softplus(-lam.astype(jnp.float32))
    return jnp.exp(log_a), jnp.sqrt(-jnp.expm1(2.0 * log_a)) * (i * u)


def rglru_scans(xa, conv_w, conv_b, gate_w, gate_b, lam, h0_f, h0_b):
    u = dwconv(xa, conv_w, conv_b, RG_CONV // 2).astype(jnp.float32)
    states = []
    for d, (h0, rev) in enumerate(((h0_f, False), (h0_b, True))):
        a, bx = rglru_coeffs(u, gate_w[d], gate_b[d], lam[d])
        a_cum, b_cum = lax.associative_scan(_affine_combine, (a, bx), reverse=rev, axis=1)
        states.append(a_cum * h0[:, None, :] + b_cum)
    return states[0], states[1]


def multi_pool(u):
    n = u.shape[-2]
    uf = u.astype(jnp.float32)
    csum = jnp.concatenate([jnp.zeros_like(uf[..., :1, :]), jnp.cumsum(uf, axis=-2)], axis=-2)
    pos = jnp.arange(n)
    outs = []
    for g, win in enumerate(POOL_WINDOWS):
        lo = jnp.clip(pos - win // 2, 0, n)
        hi = jnp.clip(pos + win - win // 2, 0, n)
        cg = csum[..., g * POOL_GW:(g + 1) * POOL_GW]
        tot = jnp.take(cg, hi, axis=-2) - jnp.take(cg, lo, axis=-2)
        outs.append(tot / (hi - lo).astype(jnp.float32)[:, None])
    return jnp.concatenate(outs, axis=-1) - uf


def pool_branch(up, pool_w, pool_b, pool_scale, rows):
    bn, n, w = up.shape
    if rows is None:
        pooled = multi_pool(up)
    else:
        pooled = multi_pool(up.reshape(bn, rows, GRID_W, w)).reshape(bn, n, w)
    y = jnp.einsum('blgc,gcd->blgd', pooled.reshape(bn, n, POOL_GROUPS, POOL_GW), pool_w.astype(jnp.float32))
    return (y.reshape(bn, n, w) + pool_b) * pool_scale


def hyena_filter_fft(n, w1, b1, freq, w2, b2, w3):
    f32 = jnp.float32
    t = jnp.linspace(0.0, 1.0, n, dtype=f32)[:, None]
    wpos = 2.0 * math.pi * jnp.arange(n, dtype=f32)[:, None] / n
    bands = jnp.linspace(1e-4, HY_BANDS - 1, HY_BANDS, dtype=f32)[None, :]
    feats = jnp.concatenate([t, jnp.cos(bands * wpos), -jnp.sin(bands * wpos)], axis=-1)
    fr = freq.astype(f32)
    hid = jnp.sin(fr * (feats @ w1.astype(f32) + b1.astype(f32)))
    hid = jnp.sin(fr * (hid @ w2.astype(f32) + b2.astype(f32)))
    filt = (hid @ w3.astype(f32)).reshape(n, HY_ORDER, 2, W_C)
    deltas = jnp.abs(jnp.linspace(math.log(HY_TARGET) / HY_FAST, math.log(HY_TARGET) / HY_SLOW, W_C, dtype=f32))
    filt = filt * jnp.exp(-t[:, :, None, None] * deltas)
    fwd, bwd = filt[:, :, 0], filt[:, :, 1]
    circ = jnp.concatenate([fwd, jnp.zeros((1, HY_ORDER, W_C), f32), bwd[1:][::-1]], axis=0)
    return jnp.fft.rfft(circ, axis=0)


def fftconv(u, filt_f):
    n = u.shape[1]
    spec = jnp.fft.rfft(u, n=2 * n, axis=1) * filt_f
    return jnp.fft.irfft(spec, n=2 * n, axis=1)[:, :n]


def hyena_branch(uh, conv_w, conv_b, skip, filt_f):
    z = dwconv(uh, conv_w, conv_b, HY_SHORT // 2).astype(jnp.float32)
    v, x1, x2 = jnp.split(z, 3, axis=-1)
    sk = skip.astype(jnp.float32)
    y = x1 * (fftconv(v, filt_f[:, 0]) + sk[0] * v)
    return x2 * (fftconv(y, filt_f[:, 1]) + sk[1] * y)


def merge_heads(proj, hf, hb, w_out, pool, hy, filt_f, rows):
    ga = proj[..., W_A:2 * W_A]
    up = proj[..., 2 * W_A:2 * W_A + W_B]
    uh = proj[..., 2 * W_A + W_B:]
    y_a = (hf + hb) * jax.nn.gelu(ga.astype(jnp.float32))
    y_b = pool_branch(up, *pool, rows)
    y_c = hyena_branch(uh, *hy, filt_f)
    return jnp.concatenate([y_a, y_b, y_c], axis=-1).astype(proj.dtype) @ w_out


def setup_inputs(seed: int = 0) -> dict:
    key = jax.random.key(seed)
    ks = jax.random.split(key, 32)
    f32 = jnp.float32

    def nrm(k, shape, scale):
        return jax.random.normal(k, shape, f32) * scale

    u_lam = jax.random.uniform(ks[15], (DEPTH, 2, W_A), f32, 0.9, 0.999)
    a0 = u_lam ** (1.0 / RG_C)
    return {
        'x': nrm(ks[0], (BATCH, SEQ, D_MODEL), 1.0),
        'c': nrm(ks[1], (BATCH, D_MODEL), 1.0),
        'ctx': nrm(ks[2], (BATCH, CTX_LEN, D_MODEL), 1.0),
        'c_ctx': nrm(ks[3], (D_MODEL,), 1.0),
        'w_mod': nrm(ks[4], (DEPTH, D_MODEL, N_MOD * D_MODEL), 0.5 * D_MODEL ** -0.5),
        'b_mod': nrm(ks[5], (DEPTH, N_MOD * D_MODEL), 0.02),
        'norm_g': 1.0 + nrm(ks[6], (DEPTH, 3, D_MODEL), 0.05),
        'ffn_w_in': nrm(ks[7], (DEPTH, 2, D_MODEL, 2 * D_FF), D_MODEL ** -0.5),
        'ffn_w_out': nrm(ks[8], (DEPTH, 2, D_FF, D_MODEL), D_FF ** -0.5),
        'w_in': nrm(ks[9], (DEPTH, D_MODEL, D_IN), D_MODEL ** -0.5),
        'w_out': nrm(ks[10], (DEPTH, D_MIX, D_MODEL), D_MIX ** -0.5),
        'lru_conv_w': nrm(ks[11], (DEPTH, RG_CONV, W_A), RG_CONV ** -0.5),
        'lru_conv_b': nrm(ks[12], (DEPTH, W_A), 0.02),
        'lru_gate_w': nrm(ks[13], (DEPTH, 2, 2, RG_HEADS, RG_HD, RG_HD), RG_HD ** -0.5),
        'lru_gate_b': nrm(ks[14], (DEPTH, 2, 2, W_A), 0.02),
        'lru_lambda': jnp.log(a0) - jnp.log1p(-a0),
        'pool_w': nrm(ks[16], (DEPTH, POOL_GROUPS, POOL_GW, POOL_GW), POOL_GW ** -0.5),
        'pool_b': nrm(ks[17], (DEPTH, W_B), 0.02),
        'pool_scale': 1.0 + nrm(ks[18], (DEPTH, W_B), 0.05),
        'hy_conv_w': nrm(ks[19], (DEPTH, HY_SHORT, 3 * W_C), HY_SHORT ** -0.5),
        'hy_conv_b': nrm(ks[20], (DEPTH, 3 * W_C), 0.02),
        'hy_w1': nrm(ks[21], (DEPTH, HY_EMB, HY_FH), HY_EMB ** -0.5),
        'hy_b1': nrm(ks[22], (DEPTH, HY_FH), 0.02),
        'hy_freq': 1.0 + nrm(ks[23], (DEPTH, HY_FH), 0.05),
        'hy_w2': nrm(ks[24], (DEPTH, HY_FH, HY_FH), HY_FH ** -0.5),
        'hy_b2': nrm(ks[25], (DEPTH, HY_FH), 0.02),
        'hy_w3': nrm(ks[26], (DEPTH, HY_FH, HY_ORDER * 2 * W_C), 0.05 * HY_FH ** -0.5),
        'hy_skip': nrm(ks[27], (DEPTH, HY_ORDER, W_C), 0.5),
        'final_g': 1.0 + nrm(ks[28], (D_MODEL,), 0.05),
    }


def reference(x, c, ctx, c_ctx, w_mod, b_mod, norm_g, ffn_w_in, ffn_w_out, w_in, w_out,
              lru_conv_w, lru_conv_b, lru_gate_w, lru_gate_b, lru_lambda,
              pool_w, pool_b, pool_scale, hy_conv_w, hy_conv_b,
              hy_w1, hy_b1, hy_freq, hy_w2, hy_b2, hy_w3, hy_skip, final_g):
    bn, n, _ = x.shape
    n_ctx = ctx.shape[1]
    rows = n // GRID_W
    zeros = jnp.zeros((bn, W_A), jnp.float32)
    xc = ctx
    for l in range(DEPTH):
        last = l == DEPTH - 1
        m_x = (jax.nn.silu(c) @ w_mod[l] + b_mod[l]).reshape(bn, N_MOD, 1, D_MODEL)
        m_c = (jax.nn.silu(c_ctx) @ w_mod[l] + b_mod[l]).reshape(N_MOD, D_MODEL)
        mx = [m_x[:, j] for j in range(N_MOD)]
        mc = [m_c[j] for j in range(N_MOD)]
        lru = (lru_conv_w[l], lru_conv_b[l], lru_gate_w[l], lru_gate_b[l], lru_lambda[l])
        pool = (pool_w[l], pool_b[l], pool_scale[l])
        hy = (hy_conv_w[l], hy_conv_b[l], hy_skip[l])
        filt_args = (hy_w1[l], hy_b1[l], hy_freq[l], hy_w2[l], hy_b2[l], hy_w3[l])

        x = x + 0.5 * mx[2] * swiglu(adanorm(x, norm_g[l, 0], mx[0], mx[1]), ffn_w_in[l, 0], ffn_w_out[l, 0])
        xc = xc + 0.5 * mc[2] * swiglu(adanorm(xc, norm_g[l, 0], mc[0], mc[1]), ffn_w_in[l, 0], ffn_w_out[l, 0])

        hc = adanorm(xc, norm_g[l, 1], mc[3], mc[4])
        if last:
            hf_c, hb_c = rglru_scans(hc @ w_in[l][:, :W_A], *lru, zeros, zeros)
        else:
            proj_c = hc @ w_in[l]
            hf_c, hb_c = rglru_scans(proj_c[..., :W_A], *lru, zeros, zeros)
            y_ctx = merge_heads(proj_c, hf_c, hb_c, w_out[l], pool, hy,
                                hyena_filter_fft(n_ctx, *filt_args), None)
            xc = xc + mc[5] * y_ctx

        h = adanorm(x, norm_g[l, 1], mx[3], mx[4])
        proj = h @ w_in[l]
        hf, hb = rglru_scans(proj[..., :W_A], *lru, hf_c[:, -1], hb_c[:, 0])
        y = merge_heads(proj, hf, hb, w_out[l], pool, hy, hyena_filter_fft(n, *filt_args), rows)
        x = x + mx[5] * y

        x = x + 0.5 * mx[8] * swiglu(adanorm(x, norm_g[l, 2], mx[6], mx[7]), ffn_w_in[l, 1], ffn_w_out[l, 1])
        if not last:
            xc = xc + 0.5 * mc[8] * swiglu(adanorm(xc, norm_g[l, 2], mc[6], mc[7]), ffn_w_in[l, 1], ffn_w_out[l, 1])
    return rmsnorm(x, final_g)
```

```cpp
#include <hip/hip_runtime.h>
#include <cstdio>
#include <cstdint>
#include <cmath>
namespace pg8 {
#define PG8_LAS __attribute__((address_space(3)))
typedef unsigned short bf16_t;
typedef short bf16x8 __attribute__((ext_vector_type(8)));
typedef float f32x4 __attribute__((ext_vector_type(4)));
typedef unsigned u32x4 __attribute__((ext_vector_type(4)));
constexpr int BM = 256, BK = 64, HALF = 128, HTB = HALF * BK * 2  , STAGE_BYTES = 8 * HTB, NXCD = 8, WGM = 8;

__host__ __device__ __forceinline__ int lds_byte(int r, int c) { const int st = (r >> 4) * 2 + (c >> 5), rr = r & 15, cc = c & 31, ob = rr * 64 + cc * 2; return st * 1024 + (ob ^ (((ob >> 9) & 1) << 5)); }
__host__ __device__ __forceinline__ void stage_rc(int b, int& R, int& C) { const int st = b / 1024, sb = b % 1024, swz = sb ^ (((sb >> 9) & 1) << 5); R = (st >> 1) * 16 + swz / 64; C = (st & 1) * 32 + (swz % 64) / 2; }
__host__ __device__ __forceinline__ int perm32(int rho) { const int n = rho >> 4, i = rho & 15; return 8 * (i >> 2) + 4 * n + (i & 3); }

struct Unit { int pm, pn; };
struct Gemm { const bf16_t* A; const bf16_t* Bt; int M, N, K; };

struct StaticOrder {
    int nM, nN, nwg, G, c;
    __host__ __device__ void init(int M, int N, int G_, int c_) { nM = M / BM; nN = N / BM; nwg = nM * nN; G = G_; c = c_; }
    __host__ __device__ bool next(int i, Unit& u) const {
        const long L = (long)i * G + c; if (L >= nwg) return false;
        int wgid = (int)L; { const int q = nwg / NXCD, r = nwg % NXCD, xcd = wgid % NXCD, off = wgid / NXCD; wgid = (xcd < r ? xcd * (q + 1) : r * (q + 1) + (xcd - r) * q) + off; }
        const int nig = WGM * nN, gid = wgid / nig, fm = gid * WGM, gsz = (nM - fm) < WGM ? (nM - fm) : WGM;
        u.pm = fm + ((wgid % nig) % gsz); u.pn = (wgid % nig) / gsz; return true;
    }
    __device__ __forceinline__ void a_ready(const Unit&) const {}
    __device__ __forceinline__ void done(const Unit&) const {}
};

__device__ __forceinline__ unsigned cvt_pk_bf16(float lo, float hi) { unsigned r; asm volatile("v_cvt_pk_bf16_f32 %0, %1, %2" : "=v"(r) : "v"(lo), "v"(hi)); return r; }
typedef float f32x2 __attribute__((ext_vector_type(2)));
typedef unsigned u32x2 __attribute__((ext_vector_type(2)));
__device__ __forceinline__ int batch_of(int pm) { return pm < 32 ? 0 : (pm < 64 ? 1 : 2); }
__device__ __forceinline__ float rstd_row(const float* ssq, int row) {
    const f32x4 a = *(const f32x4*)(ssq + (size_t)row * 4);
    return 1.0f / sqrtf(((a.x + a.y) + (a.z + a.w)) * (1.0f / 1024.0f) + 1e-6f);
}
__device__ __forceinline__ float silu_f(float x) { return x * __builtin_amdgcn_rcpf(1.0f + __expf(-x)); }

struct EpiFfnIn {
    static constexpr bool PERM = true, AFTER_DRAIN = false;
    bf16_t* act; const float* ssq; const float* bias;
    __device__ __forceinline__ void operator()(const f32x4 (&acc)[2][2][4][2], const Unit& u, int wr, int wc, int fr, int fq) const {
        const int b = batch_of(u.pm);
        const float* bp = bias + b * 5632 + u.pn * 256 + wc * 32 + 8 * fq;
        f32x4 bv[2][2];
#pragma unroll
        for (int bj = 0; bj < 2; ++bj)
#pragma unroll
            for (int n = 0; n < 2; ++n) bv[bj][n] = *(const f32x4*)(bp + bj * HALF + 4 * n);
        const int row0 = u.pm * BM + wr * 64 + fr;
        float rsv[2][4];
#pragma unroll
        for (int ai = 0; ai < 2; ++ai)
#pragma unroll
            for (int m = 0; m < 4; ++m) rsv[ai][m] = rstd_row(ssq, row0 + ai * HALF + m * 16);
#pragma unroll
        for (int ai = 0; ai < 2; ++ai)
#pragma unroll
            for (int m = 0; m < 4; ++m) {
                const int row = row0 + ai * HALF + m * 16;
                const float rs = rsv[ai][m];
                u32x4 w;
#pragma unroll
                for (int n = 0; n < 2; ++n) {
                    const f32x4 g = acc[ai][0][m][n] * rs + bv[0][n], v = acc[ai][1][m][n] * rs + bv[1][n];
                    const unsigned lo = cvt_pk_bf16(silu_f(g[0]) * v[0], silu_f(g[1]) * v[1]), hi = cvt_pk_bf16(silu_f(g[2]) * v[2], silu_f(g[3]) * v[3]);
                    if (n == 0) { w.x = lo; w.y = hi; } else { w.z = lo; w.w = hi; }
                }
                *(u32x4*)(act + (size_t)row * 2816 + u.pn * 128 + wc * 32 + 8 * fq) = w;
            }
    }
};

template <bool HALFG> struct EpiResid {
    static constexpr bool PERM = false, AFTER_DRAIN = false;
    const float* base_lat; const float* base_ctx; float* out_lat; float* out_ctx; bf16_t* xb; float* ssq;
    const float* gate; const float* gn; const float* scn;
    PG8_LAS float* red;
    __device__ __forceinline__ void operator()(const f32x4 (&acc)[2][2][4][2], const Unit& u, int wr, int wc, int fr, int fq) const {
        const int b = batch_of(u.pm);
        const float* bs = u.pm < 64 ? base_lat + (size_t)u.pm * BM * 1024 : base_ctx + (size_t)(u.pm - 64) * BM * 1024;
        float* os = u.pm < 64 ? out_lat + (size_t)u.pm * BM * 1024 : out_ctx + (size_t)(u.pm - 64) * BM * 1024;
        bf16_t* xs = xb + (size_t)u.pm * BM * 1024;
        const float* gate_ = gate + b * 9216; const float* scn_ = scn + b * 9216; const float* gn_ = gn; const float gscale_ = HALFG ? 0.5f : 1.0f;
        float* ssq_ = ssq; PG8_LAS float* red_ = red; const int pm_ = u.pm, pn_ = u.pn;
        const int col0 = u.pn * BM + wc * 32 + 4 * fq;
        float sq[2][4];
#pragma unroll
        for (int ai = 0; ai < 2; ++ai)
#pragma unroll
            for (int m = 0; m < 4; ++m) sq[ai][m] = 0.f;
#pragma unroll
        for (int bj = 0; bj < 2; ++bj)
#pragma unroll
            for (int n = 0; n < 2; ++n) {
                const int col = col0 + bj * HALF + n * 16;
                const f32x4 gv = *(const f32x4*)(gate_ + col) * gscale_;
                f32x4 Gv = (f32x4){1.f, 1.f, 1.f, 1.f};
                if (gn_) { const f32x4 s = *(const f32x4*)(scn_ + col); Gv = *(const f32x4*)(gn_ + col) * (s + 1.0f); }
#pragma unroll
                for (int ai = 0; ai < 2; ++ai)
#pragma unroll
                    for (int m = 0; m < 4; ++m) {
                        const size_t off = (size_t)(ai * HALF + wr * 64 + m * 16 + fr) * 1024 + col;
                        const f32x4 xn = *(const f32x4*)(bs + off) + gv * acc[ai][bj][m][n];
                        *(f32x4*)(os + off) = xn;
                        sq[ai][m] += (xn[0] * xn[0] + xn[1] * xn[1]) + (xn[2] * xn[2] + xn[3] * xn[3]);
                        const f32x4 o = xn * Gv; u32x2 w; w.x = cvt_pk_bf16(o[0], o[1]); w.y = cvt_pk_bf16(o[2], o[3]);
                        *(u32x2*)(xs + off) = w; }
                asm volatile("" ::: "memory");
            }
#pragma unroll
        for (int ai = 0; ai < 2; ++ai)
#pragma unroll
            for (int m = 0; m < 4; ++m) { float s = sq[ai][m]; s += __shfl_xor(s, 16); s += __shfl_xor(s, 32);
                if (fq == 0) red_[(ai * HALF + wr * 64 + m * 16 + fr) * 4 + wc] = s; }
        asm volatile("s_waitcnt lgkmcnt(0)" ::: "memory"); __builtin_amdgcn_s_barrier(); asm volatile("" ::: "memory");
        const int tid = (wr * 4 + wc) * 64 + fq * 16 + fr;
        if (tid < 256) { const f32x4 p = *(const PG8_LAS f32x4*)(red_ + tid * 4); ssq_[(size_t)(pm_ * BM + tid) * 4 + pn_] = (p.x + p.y) + (p.z + p.w); }
    }
};

struct EpiProj {
    static constexpr bool PERM = false, AFTER_DRAIN = false;
    float* xa; bf16_t* ga; bf16_t* up; float* zt; const float* ssq; const float* bias;
    __device__ __forceinline__ void operator()(const f32x4 (&acc)[2][2][4][2], const Unit& u, int wr, int wc, int fr, int fq) const {
        const int b = batch_of(u.pm);
        const int col0 = u.pn * BM + wc * 32 + 4 * fq;
        float rsv[2][4];
#pragma unroll
        for (int ai = 0; ai < 2; ++ai)
#pragma unroll
            for (int m = 0; m < 4; ++m) rsv[ai][m] = rstd_row(ssq, u.pm * BM + ai * HALF + wr * 64 + m * 16 + fr);
#pragma unroll
        for (int bj = 0; bj < 2; ++bj)
#pragma unroll
            for (int n = 0; n < 2; ++n) {
                const int col = col0 + bj * HALF + n * 16;
                const f32x4 bv = *(const f32x4*)(bias + b * 5632 + col);
#pragma unroll
                for (int ai = 0; ai < 2; ++ai)
#pragma unroll
                    for (int m = 0; m < 4; ++m) {
                        const int row = u.pm * BM + ai * HALF + wr * 64 + m * 16 + fr;
                        const f32x4 v = acc[ai][bj][m][n] * rsv[ai][m] + bv;
                        if (u.pn < 2) *(f32x4*)(xa + (size_t)row * 512 + col) = v;
                        else if (u.pn < 4) { u32x2 w; w.x = cvt_pk_bf16(v[0], v[1]); w.y = cvt_pk_bf16(v[2], v[3]); *(u32x2*)(ga + (size_t)row * 512 + (col - 512)) = w; }
                        else if (u.pn < 5) { u32x2 w; w.x = cvt_pk_bf16(v[0], v[1]); w.y = cvt_pk_bf16(v[2], v[3]); *(u32x2*)(up + (size_t)row * 256 + (col - 1024)) = w; }
                        else { float* z = zt + (size_t)(col - 1280) * 16896 + row; z[0] = v[0]; z[16896] = v[1]; z[2 * 16896] = v[2]; z[3 * 16896] = v[3]; } }
            }
    }
};
template <class Epi, class Sched, bool ALIGN_EPI = false, bool SP2 = false>
__device__ __forceinline__ void gemm_phase(PG8_LAS unsigned char* lds, const Gemm g, const Sched& S, const Epi& E) {
    int tid_l = threadIdx.x; asm volatile("" : "+v"(tid_l));
    const int tid = tid_l, wid = __builtin_amdgcn_readfirstlane(tid >> 6), lane = tid & 63, wr = wid >> 2, wc = wid & 3, fr = lane & 15, fq = lane >> 4;
    const int K = g.K, nt = K / BK;
    unsigned voffA[2], voffB[2];
#pragma unroll
    for (int i = 0; i < 2; ++i) { int R, C; stage_rc(tid * 16 + i * 8192, R, C); const int Rb = Epi::PERM ? ((R & ~31) + perm32(R & 31)) : R;
        voffA[i] = (unsigned)(R * K + C) * 2u; voffB[i] = (unsigned)(Rb * K + C) * 2u; }
    const size_t kstep = (size_t)(BK * 2);
    const size_t hstep = (size_t)HALF * K * 2;
    const size_t tstep = 2 * hstep;
    const unsigned ldsw = (unsigned)wid * 1024u;
    const int aoff = lds_byte(wr * 64 + fr, fq * 8), boff = lds_byte(wc * 32 + fr, fq * 8);
#define PG8_SA(b, h) (((b) * 2 + (h)) * HTB)
#define PG8_SB(b, h) ((4 + (b) * 2 + (h)) * HTB)
#define PG8_STAGE(bufoff, gbase, voff) do { _Pragma("unroll") for (int _i = 0; _i < 2; ++_i) \
        __builtin_amdgcn_global_load_lds((const unsigned*)((const char*)(gbase) + (voff)[_i]), (PG8_LAS unsigned*)(lds + (bufoff) + ldsw + _i * 8192), 16, 0, 0); } while (0)
#define PG8_LDA(dst, b, h) do { _Pragma("unroll") for (int m = 0; m < 4; ++m) _Pragma("unroll") for (int k = 0; k < 2; ++k) dst[m][k] = *(const PG8_LAS bf16x8*)(lds + PG8_SA(b, h) + aoff + m * 2048 + k * 1024); } while (0)
#define PG8_LDB(dst, b, h) do { _Pragma("unroll") for (int n = 0; n < 2; ++n) _Pragma("unroll") for (int k = 0; k < 2; ++k) dst[n][k] = *(const PG8_LAS bf16x8*)(lds + PG8_SB(b, h) + boff + n * 2048 + k * 1024); } while (0)
#define PG8_MMA(ai, bj, At, Bt) do { __builtin_amdgcn_s_setprio(1); _Pragma("unroll") for (int m = 0; m < 4; ++m) _Pragma("unroll") for (int n = 0; n < 2; ++n) _Pragma("unroll") for (int k = 0; k < 2; ++k) \
        acc[ai][bj][m][n] = __builtin_amdgcn_mfma_f32_16x16x32_bf16(Bt[n][k], At[m][k], acc[ai][bj][m][n], 0, 0, 0); __builtin_amdgcn_s_setprio(0); } while (0)
#define PG8_WAIT_V(n) asm volatile("s_waitcnt vmcnt(" #n ")" ::: "memory")
#define PG8_WAIT_L(n) asm volatile("s_waitcnt lgkmcnt(" #n ")" ::: "memory")
#define PG8_BAR __builtin_amdgcn_s_barrier()
#define PG8_SCHED __builtin_amdgcn_sched_barrier(0)
    Unit cur, nxt; int ui = 0;
    if (!S.next(0, cur)) return;
    f32x4 acc[2][2][4][2];
#pragma unroll
    for (int a = 0; a < 2; ++a)
#pragma unroll
        for (int b = 0; b < 2; ++b)
#pragma unroll
            for (int m = 0; m < 4; ++m)
#pragma unroll
                for (int n = 0; n < 2; ++n) acc[a][b][m][n] = (f32x4){0.f, 0.f, 0.f, 0.f};
    bf16x8 At[4][2], B0[2][2], B1[2][2];
    const char* cA = (const char*)g.A + (size_t)cur.pm * tstep; const char* cB = (const char*)g.Bt + (size_t)cur.pn * tstep;
    S.a_ready(cur);
    if constexpr (SP2) {
        PG8_STAGE(PG8_SB(0, 0), cB, voffB); PG8_STAGE(PG8_SB(0, 1), cB + hstep, voffB); PG8_STAGE(PG8_SA(0, 0), cA, voffA); PG8_STAGE(PG8_SA(0, 1), cA + hstep, voffA);
        if (wr == 1) PG8_BAR;
        PG8_WAIT_V(2); PG8_BAR;
        PG8_STAGE(PG8_SB(1, 0), cB + kstep, voffB); PG8_STAGE(PG8_SA(1, 0), cA + kstep, voffA); PG8_STAGE(PG8_SB(1, 1), cB + hstep + kstep, voffB);
        PG8_WAIT_V(6); PG8_BAR;
    } else {
        PG8_STAGE(PG8_SB(0, 0), cB, voffB); PG8_STAGE(PG8_SA(0, 0), cA, voffA); PG8_STAGE(PG8_SB(0, 1), cB + hstep, voffB); PG8_STAGE(PG8_SA(0, 1), cA + hstep, voffA);
        if (wr == 1) PG8_BAR;
        PG8_WAIT_V(4); PG8_BAR;
        PG8_STAGE(PG8_SB(1, 0), cB + kstep, voffB); PG8_STAGE(PG8_SA(1, 0), cA + kstep, voffA); PG8_STAGE(PG8_SB(1, 1), cB + hstep + kstep, voffB);
        PG8_WAIT_V(6); PG8_BAR;
    }
    for (;;) {
        const bool has_next = S.next(ui + 1, nxt);
        const char* nA = has_next ? (const char*)g.A + (size_t)nxt.pm * tstep : cA; const char* nB = has_next ? (const char*)g.Bt + (size_t)nxt.pn * tstep : cB;
        for (int t = 0; t < nt; t += 2) {
            const bool last = (t == nt - 2);
            const char* a1 = cA + (size_t)(t + 1) * kstep;
            const char* a2 = last ? nA : cA + (size_t)(t + 2) * kstep; const char* b2 = last ? nB : cB + (size_t)(t + 2) * kstep;
            const char* a3 = a2 + kstep; const char* b3 = b2 + kstep;
            if (last && has_next) S.a_ready(nxt);
            if constexpr (SP2) {
            PG8_LDB(B0, 0, 0); PG8_LDB(B1, 0, 1); PG8_SCHED; PG8_LDA(At, 0, 0); PG8_STAGE(PG8_SA(1, 1), a1 + hstep, voffA);
            PG8_WAIT_V(8); PG8_WAIT_L(0); PG8_BAR; PG8_MMA(0, 0, At, B0); PG8_MMA(0, 1, At, B1); PG8_BAR; PG8_SCHED;
            PG8_LDA(At, 0, 1); PG8_STAGE(PG8_SB(0, 0), b2, voffB); PG8_STAGE(PG8_SB(0, 1), b2 + hstep, voffB); PG8_STAGE(PG8_SA(0, 0), a2, voffA);
            PG8_WAIT_V(8); PG8_WAIT_L(0); PG8_BAR; PG8_MMA(1, 0, At, B0); PG8_MMA(1, 1, At, B1); PG8_BAR; PG8_SCHED;
            PG8_LDB(B0, 1, 0); PG8_LDB(B1, 1, 1); PG8_SCHED; PG8_LDA(At, 1, 0); PG8_STAGE(PG8_SA(0, 1), a2 + hstep, voffA);
            PG8_WAIT_V(8); PG8_WAIT_L(0); PG8_BAR; PG8_MMA(0, 0, At, B0); PG8_MMA(0, 1, At, B1); PG8_BAR; PG8_SCHED;
            PG8_LDA(At, 1, 1); PG8_STAGE(PG8_SB(1, 0), b3, voffB); PG8_STAGE(PG8_SB(1, 1), b3 + hstep, voffB); PG8_STAGE(PG8_SA(1, 0), a3, voffA);
            PG8_WAIT_V(8); PG8_WAIT_L(0); PG8_BAR; PG8_MMA(1, 0, At, B0); PG8_MMA(1, 1, At, B1); PG8_BAR; PG8_SCHED;
            } else {
            PG8_LDB(B0, 0, 0); PG8_SCHED; PG8_LDA(At, 0, 0); PG8_STAGE(PG8_SA(1, 1), a1 + hstep, voffA);
            PG8_WAIT_L(8); PG8_BAR; PG8_WAIT_L(0); PG8_MMA(0, 0, At, B0); PG8_BAR; PG8_SCHED;
            PG8_LDB(B1, 0, 1); PG8_STAGE(PG8_SB(0, 0), b2, voffB);
            PG8_BAR; PG8_WAIT_L(0); PG8_MMA(0, 1, At, B1); PG8_BAR;
            PG8_LDA(At, 0, 1); PG8_STAGE(PG8_SA(0, 0), a2, voffA);
            PG8_BAR; PG8_WAIT_L(0); PG8_MMA(1, 0, At, B0); PG8_BAR; PG8_SCHED;
            PG8_STAGE(PG8_SB(0, 1), b2 + hstep, voffB);
            PG8_WAIT_V(6); PG8_BAR; PG8_MMA(1, 1, At, B1); PG8_BAR;
            PG8_LDB(B0, 1, 0); PG8_SCHED; PG8_LDA(At, 1, 0); PG8_STAGE(PG8_SA(0, 1), a2 + hstep, voffA);
            PG8_WAIT_L(8); PG8_BAR; PG8_WAIT_L(0); PG8_MMA(0, 0, At, B0); PG8_BAR; PG8_SCHED;
            PG8_LDB(B1, 1, 1); PG8_STAGE(PG8_SB(1, 0), b3, voffB);
            PG8_BAR; PG8_WAIT_L(0); PG8_MMA(0, 1, At, B1); PG8_BAR;
            PG8_LDA(At, 1, 1); PG8_STAGE(PG8_SA(1, 0), a3, voffA);
            PG8_BAR; PG8_WAIT_L(0); PG8_MMA(1, 0, At, B0); PG8_BAR; PG8_SCHED;
            PG8_STAGE(PG8_SB(1, 1), b3 + hstep, voffB);
            PG8_WAIT_V(6); PG8_BAR; PG8_MMA(1, 1, At, B1); PG8_BAR;
            }
        }
        if constexpr (ALIGN_EPI) { if (wr == 0) PG8_BAR; }
        if constexpr (!Epi::AFTER_DRAIN) { E(acc, cur, wr, wc, fr, fq); S.done(cur); }
        if (!has_next) break;
#pragma unroll
        for (int a = 0; a < 2; ++a)
#pragma unroll
            for (int b = 0; b < 2; ++b)
#pragma unroll
                for (int m = 0; m < 4; ++m)
#pragma unroll
                    for (int n = 0; n < 2; ++n) acc[a][b][m][n] = (f32x4){0.f, 0.f, 0.f, 0.f};
        cur = nxt; cA = nA; cB = nB; ++ui;
        if constexpr (ALIGN_EPI) { if (wr == 1) PG8_BAR; }
    }
    PG8_WAIT_V(0);
    if constexpr (!ALIGN_EPI) { if (wr == 0) PG8_BAR; }
    PG8_BAR;
    if constexpr (Epi::AFTER_DRAIN) { E.fused(acc, cur, wr, wc, fr, fq, lds, wid, lane); S.done(cur); }
#undef PG8_SA
#undef PG8_SB
#undef PG8_STAGE
#undef PG8_LDA
#undef PG8_LDB
#undef PG8_MMA
#undef PG8_WAIT_V
#undef PG8_WAIT_L
#undef PG8_BAR
#undef PG8_SCHED
}
}
constexpr int NWAVES = 8;
constexpr int DM = 1024, SEQ = 8192, NBATCH = 2, CTXL = 256;
constexpr int MLAT = NBATCH * SEQ, MCTX = NBATCH * CTXL, MROWS = MLAT + MCTX, NPANEL = MROWS / 256;
constexpr int DFF = 2816, NFF = 2 * DFF, DIN = 2048;
static_assert(NPANEL == 66 && MROWS == 16896, "rows");
enum { I_X = 0, I_C, I_CTX, I_CCTX, I_WMOD, I_BMOD, I_NORMG, I_FFNWIN, I_FFNWOUT, I_WIN, I_WOUT, I_LCW, I_LCB, I_LGW, I_LGB, I_LLAM, I_PW, I_PB, I_PS, I_HCW, I_HCB, I_HW1, I_HB1, I_HFREQ, I_HW2, I_HB2, I_HW3, I_HSKIP, I_FINALG, N_INPUTS };
static_assert(N_INPUTS == 29, "inputs");

constexpr size_t MiB = 1u << 20;
constexpr size_t WS_CTL = 0, CTL_ZERO_BYTES = 1 * MiB;
constexpr size_t WS_MOD = 1 * MiB;
constexpr size_t WS_BIAS = 1 * MiB + 512 * 1024;
constexpr size_t WS_WG = 2 * MiB;
constexpr size_t WS_WPL = 2 * MiB + 512 * 1024;
constexpr size_t WS_SUM = 3 * MiB;
constexpr size_t WS_SUMW = 4 * MiB;
constexpr size_t WS_SSQ = 9 * MiB;
constexpr size_t WS_HID2 = 11 * MiB;
constexpr size_t WS_FILTC = 16 * MiB;
constexpr size_t WS_XC = 18 * MiB;
constexpr size_t WS_WT1 = 20 * MiB;
constexpr size_t WS_WT2 = 64 * MiB;
constexpr size_t WS_WTP = 86 * MiB;
constexpr size_t WS_WTO = 94 * MiB;
constexpr size_t WS_XB = 98 * MiB;
constexpr size_t WS_FILT = 131 * MiB;
constexpr size_t WS_OVL = 163 * MiB;
constexpr size_t WS_ACT = WS_OVL;
constexpr size_t WS_XA = WS_OVL;
constexpr size_t WS_GA = 196 * MiB;
constexpr size_t WS_UP = 213 * MiB;
constexpr size_t WS_ZT = 222 * MiB;
constexpr size_t WS_YCT = 272 * MiB;
constexpr size_t WS_YC = 289 * MiB;
constexpr size_t WS_END = 322 * MiB;
static_assert(WS_ACT + (size_t)MROWS * DFF * 2 <= WS_END && WS_XA + (size_t)MROWS * 512 * 4 <= WS_GA && WS_GA + (size_t)MROWS * 512 * 2 <= WS_UP && WS_UP + (size_t)MROWS * 256 * 2 <= WS_ZT &&
              WS_ZT + (size_t)768 * MROWS * 4 <= WS_YCT && WS_YCT + (size_t)256 * MROWS * 4 <= WS_YC && WS_YC + (size_t)MROWS * 1024 * 2 <= WS_END, "overlay map");
static_assert(WS_XB + (size_t)MROWS * 1024 * 2 <= WS_FILT && WS_FILT + (size_t)1024 * 8192 * 4 <= WS_OVL && WS_WT1 + (size_t)4 * NFF * 1024 * 2 <= WS_WT2 && WS_WT2 + (size_t)4 * 1024 * DFF * 2 <= WS_WTP, "map");
static_assert(WS_SUMW + (size_t)66 * 8 * 2 * 2 * 512 * 4 <= WS_SSQ && WS_SSQ + (size_t)MROWS * 64 <= WS_HID2 && WS_HID2 + (size_t)2 * 8448 * 64 * 4 <= WS_FILTC && WS_BIAS + (size_t)2 * 3 * 3 * 5632 * 4 <= WS_WG, "map2");
constexpr int CW_BAR = 4096;

constexpr int RING_BYTES = 131072;
constexpr int LDSCTL_OFF = RING_BYTES, MISC_OFF = LDSCTL_OFF + 320;
constexpr int ARGS_OFF = RING_BYTES + 1024;
constexpr int RED_OFF = RING_BYTES + 2048;
constexpr int LDS_BYTES = 147456;

#define GAS __attribute__((address_space(1)))
#define LAS __attribute__((address_space(3)))
typedef unsigned short bf16;
typedef unsigned v4u __attribute__((ext_vector_type(4)));
typedef float f32x4 __attribute__((ext_vector_type(4)));
typedef short bf16x8 __attribute__((ext_vector_type(8)));
typedef GAS unsigned gu32;
typedef GAS unsigned long long gu64;
#define RLX_AGENT __ATOMIC_RELAXED, __HIP_MEMORY_SCOPE_AGENT
#define LDS_WAIT() asm volatile("s_waitcnt lgkmcnt(0)" ::: "memory")
#define VM_WAIT() asm volatile("s_waitcnt vmcnt(0)" ::: "memory")
__device__ __forceinline__ unsigned long long rt() { return __builtin_amdgcn_s_memrealtime(); }
__device__ __forceinline__ unsigned f2bf(float f) { unsigned u = __builtin_bit_cast(unsigned, f); return (u + 0x7fffu + ((u >> 16) & 1u)) >> 16; }
__device__ __forceinline__ unsigned pk2(float lo, float hi) { return f2bf(lo) | (f2bf(hi) << 16); }

#define XB_TMO      128
#define XB_XCNT(j)  (256  + 64 * (j))
#define XB_XSUB(j)  (1280 + 64 * (j))
#define XB_XGEN(j)  (2304 + 64 * (j))
#define XB_TOP      3328
#define XB_TOPGEN   3392
#define XCD_BAR_WORDS 3456
#define XB_SPIN_CAP (1u << 18)

__device__ __forceinline__ unsigned xb_ld(unsigned* p)              { return __hip_atomic_load(p, __ATOMIC_RELAXED, __HIP_MEMORY_SCOPE_AGENT); }
__device__ __forceinline__ unsigned xb_add(unsigned* p, unsigned v) { return __hip_atomic_fetch_add(p, v, __ATOMIC_RELAXED, __HIP_MEMORY_SCOPE_AGENT); }
__device__ __forceinline__ unsigned xb_xcc_id() { return (unsigned)__builtin_amdgcn_s_getreg((3 << 11) | 20) & 0xFu; }
#define XB_SPIN(cond, bar) do { unsigned _sp = 0; while (cond) { __builtin_amdgcn_s_sleep(1); \
    if ((++_sp & 255u) == 0u) { if (xb_ld(&(bar)[XB_TMO])) break; if (_sp > XB_SPIN_CAP) { atomicAdd(&(bar)[XB_TMO], 1u); break; } } } } while (0)

struct XcdBarrier {
    unsigned* bar; unsigned x;
    volatile LAS unsigned* st;
};

__device__ __forceinline__ XcdBarrier xcd_barrier_post(unsigned* bar, volatile LAS unsigned* st) {
    XcdBarrier b; b.bar = bar; b.x = xb_xcc_id(); b.st = st;
    if (threadIdx.x == 0) (void)xb_add(&bar[XB_XCNT(b.x)], 1u);
    return b;
}
__device__ __forceinline__ void xcd_barrier_complete(unsigned* bar, unsigned x, unsigned& nloc, unsigned& nx) {
    const unsigned G = gridDim.x * gridDim.y * gridDim.z;
    unsigned sum, cnt, mine, sp = 0u;
    for (;;) {
        sum = 0u; cnt = 0u; mine = 0u;
#pragma unroll
        for (unsigned j = 0; j < 16; ++j) { const unsigned c = xb_ld(&bar[XB_XCNT(j)]); sum += c; cnt += (c > 0u) ? 1u : 0u; mine = (j == x) ? c : mine; }
        if (sum == G) break;
        __builtin_amdgcn_s_sleep(1);
        if ((++sp & 255u) == 0u) { if (xb_ld(&bar[XB_TMO])) break; if (sp > XB_SPIN_CAP) { atomicAdd(&bar[XB_TMO], 1u); break; } }
    }
    nloc = mine > 0u ? mine : 1u; nx = cnt > 0u ? cnt : 1u;
}

__device__ __forceinline__ void xcd_barrier(const XcdBarrier& b) {
    asm volatile("s_waitcnt vmcnt(0)" ::: "memory");
    __syncthreads();
    if (threadIdx.x == 0) {
        unsigned* bar = b.bar;
        __builtin_amdgcn_s_waitcnt(0);
        unsigned nloc = b.st[0], nx = b.st[1];
        if (nloc == 0u) { xcd_barrier_complete(bar, b.x, nloc, nx); b.st[0] = nloc; b.st[1] = nx; }
        const unsigned old = xb_add(&bar[XB_XSUB(b.x)], 1u);
        const unsigned gen = old / nloc;
        if (old + 1u == (gen + 1u) * nloc) {
            __builtin_amdgcn_fence(__ATOMIC_RELEASE, "agent");
            asm volatile("s_waitcnt vmcnt(0)" ::: "memory");
            const unsigned og = xb_add(&bar[XB_TOP], 1u);
            const unsigned tg = og / nx;
            if (og + 1u == (tg + 1u) * nx) xb_add(&bar[XB_TOPGEN], 1u);
            else XB_SPIN(xb_ld(&bar[XB_TOPGEN]) == tg, bar);
            __builtin_amdgcn_fence(__ATOMIC_ACQUIRE, "agent");
            xb_add(&bar[XB_XGEN(b.x)], 1u);
            asm volatile("s_waitcnt vmcnt(0)" ::: "memory");
        } else {
            XB_SPIN(xb_ld(&bar[XB_XGEN(b.x)]) == gen, bar);
            __builtin_amdgcn_fence(__ATOMIC_ACQUIRE, "agent");
            asm volatile("s_waitcnt vmcnt(0)" ::: "memory");
        }
    }
    __syncthreads();
}
typedef unsigned v2u __attribute__((ext_vector_type(2)));
typedef float f32x16 __attribute__((ext_vector_type(16)));
__device__ __forceinline__ float bf2f(unsigned h) { return __builtin_bit_cast(float, h << 16); }
__device__ __forceinline__ float wave_sum(float v) {
#pragma unroll
    for (int o = 1; o < 64; o <<= 1) v += __shfl_xor(v, o);
    return v;
}
__device__ __forceinline__ float sigmoid_f(float x) { return __builtin_amdgcn_rcpf(1.0f + __expf(-x)); }
__device__ __forceinline__ float gelu_tanh_f(float x) { const float u = 0.7978845608028654f * (x + 0.044715f * x * x * x); return x * sigmoid_f(2.0f * u); }
struct Args { const float* in[29]; float* out; unsigned char* ws; };
struct Ctx {
    volatile LAS unsigned long long* T;
    __device__ __forceinline__ unsigned long long raw(int k) const { const unsigned long long v = T[k];
        return ((unsigned long long)(unsigned)__builtin_amdgcn_readfirstlane((int)(unsigned)(v >> 32)) << 32) | (unsigned long long)(unsigned)__builtin_amdgcn_readfirstlane((int)(unsigned)v); }
    __device__ __forceinline__ const float* in(int k) const { return (const float*)raw(k); }
    __device__ __forceinline__ float* out() const { return (float*)raw(29); }
    __device__ __forceinline__ unsigned char* ws() const { return (unsigned char*)raw(30); }
};
__device__ __forceinline__ void phase_p0a(const Ctx& a, LAS unsigned char* lds, int tid, int vcu, int G) {
    const float* c = a.in(I_C); const float* c_ctx = a.in(I_CCTX); const float* w_mod = a.in(I_WMOD); const float* b_mod = a.in(I_BMOD);
    float* MOD = (float*)(a.ws() + WS_MOD);
    LAS float* sc = (LAS float*)lds; LAS float* red = sc + 3072;
    const int wave = __builtin_amdgcn_readfirstlane(tid >> 6), lane = tid & 63;
    for (int i = tid; i < 3072; i += 512) { const int b = i >> 10, k = i & 1023; const float v = b < 2 ? c[b * 1024 + k] : c_ctx[k]; sc[i] = v / (1.0f + expf(-v)); }
    __syncthreads();
    for (int it = vcu; it < 288; it += G) {
        const int l = it / 144, n0 = (it % 144) * 64;
        const float* W = w_mod + (size_t)l * 1024 * 9216 + n0 + lane;
        float a0 = 0.f, a1 = 0.f, a2 = 0.f;
        const int k0 = wave * 128;
#pragma unroll 16
        for (int kk = 0; kk < 128; ++kk) { const int k = k0 + kk; const float w = W[(size_t)k * 9216]; a0 += sc[k] * w; a1 += sc[1024 + k] * w; a2 += sc[2048 + k] * w; }
        red[(wave * 3 + 0) * 64 + lane] = a0; red[(wave * 3 + 1) * 64 + lane] = a1; red[(wave * 3 + 2) * 64 + lane] = a2;
        __syncthreads();
        if (tid < 192) { const int b = tid >> 6, n = tid & 63; float s = 0.f;
#pragma unroll
            for (int w = 0; w < 8; ++w) s += red[(w * 3 + b) * 64 + n];
            MOD[(size_t)(l * 3 + b) * 9216 + n0 + n] = s + b_mod[l * 9216 + n0 + n]; }
        __syncthreads();
    }
    float* HID2 = (float*)(a.ws() + WS_HID2);
    const int gw = vcu * NWAVES + wave, NGW = G * NWAVES;
    for (int l = 0; l < 2; ++l) {
        const float* w1 = a.in(I_HW1) + l * 33 * 64; const float* w2 = a.in(I_HW2) + l * 64 * 64;
        float w1c[33], w2c[64];
#pragma unroll
        for (int e = 0; e < 33; ++e) w1c[e] = w1[e * 64 + lane];
#pragma unroll
        for (int i = 0; i < 64; ++i) w2c[i] = w2[i * 64 + lane];
        const float fq = a.in(I_HFREQ)[l * 64 + lane], b1 = a.in(I_HB1)[l * 64 + lane], b2 = a.in(I_HB2)[l * 64 + lane];
        for (int r = gw; r < 8448; r += NGW) {
            const int n = r < 8192 ? 8192 : 256, pos = r < 8192 ? r : r - 8192;
            const float tl = (float)pos / (float)(n - 1);
            const float wpos = 6.283185307179586f * (float)pos / (float)n;
            float feat = 0.f;
            if (lane == 0) feat = tl;
            else if (lane <= 16) { const float band = 1e-4f + (float)(lane - 1) * ((15.0f - 1e-4f) / 15.0f); feat = cosf(band * wpos); }
            else if (lane <= 32) { const float band = 1e-4f + (float)(lane - 17) * ((15.0f - 1e-4f) / 15.0f); feat = -sinf(band * wpos); }
            float h1 = 0.f;
#pragma unroll
            for (int e = 0; e < 33; ++e) h1 += __shfl(feat, e) * w1c[e];
            h1 = sinf(fq * (h1 + b1));
            float h2 = 0.f;
#pragma unroll
            for (int i = 0; i < 64; ++i) h2 += __shfl(h1, i) * w2c[i];
            h2 = sinf(fq * (h2 + b2));
            HID2[((size_t)l * 8448 + r) * 64 + lane] = h2;
        }
    }
}

__device__ __forceinline__ void conv_item(const float* W, int K, int N, bf16* WT, int n0, int d0, int cb, int cn, LAS float* scr, const float* S, float* biasout, int bstride, int lane) {
    const int nl = lane & 31, kh = lane >> 5;
    LAS float* sl = scr + 64 * 33;
    float a0 = 0.f, a1 = 0.f, a2 = 0.f;
    for (int ch = cb; ch < cb + cn; ++ch) {
        const int k0 = ch * 64;
        if (S) { sl[lane] = S[k0 + lane]; sl[64 + lane] = S[9216 + k0 + lane]; sl[128 + lane] = S[18432 + k0 + lane]; LDS_WAIT(); asm volatile("" ::: "memory"); }
#pragma unroll 8
        for (int i = 0; i < 32; ++i) { const int kk = 2 * i + kh; const float w = W[(size_t)(k0 + kk) * N + n0 + nl]; scr[kk * 33 + nl] = w;
            if (S) { a0 += sl[kk] * w; a1 += sl[64 + kk] * w; a2 += sl[128 + kk] * w; } }
        LDS_WAIT(); asm volatile("" ::: "memory");
        const int c8 = lane & 7;
#pragma unroll
        for (int j = 0; j < 4; ++j) { const int n = (lane >> 3) + 8 * j; const LAS float* s = scr + (8 * c8) * 33 + n;
            v4u o; o.x = pk2(s[0 * 33], s[1 * 33]); o.y = pk2(s[2 * 33], s[3 * 33]); o.z = pk2(s[4 * 33], s[5 * 33]); o.w = pk2(s[6 * 33], s[7 * 33]);
            *(v4u*)(WT + (size_t)(d0 + n) * K + k0 + 8 * c8) = o; }
        LDS_WAIT(); asm volatile("" ::: "memory");
    }
    if (S) { a0 += __shfl_xor(a0, 32); a1 += __shfl_xor(a1, 32); a2 += __shfl_xor(a2, 32);
        if (lane < 32) { biasout[d0 + lane] = a0; biasout[bstride + d0 + lane] = a1; biasout[2 * bstride + d0 + lane] = a2; } }
}
__device__ __forceinline__ void filt_item(const Ctx& a, int l, bool isctx, int tb, int cg, int lane) {
    const int n = isctx ? 256 : 8192, pos = tb * 64 + lane;
    const float* hrow = (const float*)(a.ws() + WS_HID2) + ((size_t)l * 8448 + (isctx ? 8192 : 0) + pos) * 64;
    float* F = isctx ? (float*)(a.ws() + WS_FILTC) + (size_t)l * 1024 * 256 : (float*)(a.ws() + WS_FILT);
    const float* w3 = a.in(I_HW3) + (size_t)l * 64 * 1024;
    float h[64];
#pragma unroll
    for (int j = 0; j < 16; ++j) { const f32x4 v = *(const f32x4*)(hrow + 4 * j); h[4 * j] = v.x; h[4 * j + 1] = v.y; h[4 * j + 2] = v.z; h[4 * j + 3] = v.w; }
    const float tl = (float)pos / (float)(n - 1);
    for (int cbk = 0; cbk < 8; ++cbk) {
        const int c0 = cg * 128 + cbk * 16;
        float acc[16];
#pragma unroll
        for (int q = 0; q < 16; ++q) acc[q] = 0.f;
#pragma unroll
        for (int j = 0; j < 64; ++j)
#pragma unroll
            for (int q = 0; q < 16; ++q) acc[q] += h[j] * w3[j * 1024 + c0 + q];
#pragma unroll
        for (int q = 0; q < 16; ++q) { const int col = c0 + q, ch = col & 255;
            const float d0 = -15.350567286626973f, d1 = -3.0701134573253945f;
            const float delta = fabsf(d0 + (float)ch * ((d1 - d0) / 255.0f));
            F[(size_t)col * n + pos] = acc[q] * expf(-tl * delta); }
    }
}

__device__ __forceinline__ void phase_p0b(const Ctx& a, LAS unsigned char* lds, int tid, int vcu, int G) {
    const int wave = __builtin_amdgcn_readfirstlane(tid >> 6), lane = tid & 63;
    const int gw = vcu * NWAVES + wave, NGW = G * NWAVES;
    LAS float* scr = (LAS float*)(lds + wave * 16384);
    const float* MOD = (const float*)(a.ws() + WS_MOD);
    float* BIAS = (float*)(a.ws() + WS_BIAS);
    for (int it = gw; it < 1408; it += NGW) {
        int r = it;
        if (r < 704) { const int lf = r / 176, nb = r % 176, l = lf >> 1, f = lf & 1;
            const int n0 = nb * 32, half = n0 / DFF, j = n0 % DFF, d0 = (j / 128) * 256 + half * 128 + (j % 128);
            conv_item(a.in(I_FFNWIN) + (size_t)lf * 1024 * NFF, 1024, NFF, (bf16*)(a.ws() + WS_WT1) + (size_t)lf * NFF * 1024, n0, d0, 0, 16, scr,
                      MOD + (size_t)l * 3 * 9216 + (f == 0 ? 0 : 6) * 1024, BIAS + (size_t)(l * 3 + (f == 0 ? 0 : 2)) * 3 * 5632, 5632, lane);
            continue; }
        r -= 704;
        if (r < 128) { const int l = r / 64, nb = r % 64;
            conv_item(a.in(I_WIN) + (size_t)l * 1024 * DIN, 1024, DIN, (bf16*)(a.ws() + WS_WTP) + (size_t)l * DIN * 1024, nb * 32, nb * 32, 0, 16, scr,
                      MOD + (size_t)l * 3 * 9216 + 3 * 1024, BIAS + (size_t)(l * 3 + 1) * 3 * 5632, 5632, lane);
            continue; }
        r -= 128;
        if (r < 512) { const int lf = r / 128, q = r % 128, nb = q >> 2, seg = q & 3;
            conv_item(a.in(I_FFNWOUT) + (size_t)lf * DFF * 1024, DFF, 1024, (bf16*)(a.ws() + WS_WT2) + (size_t)lf * 1024 * DFF, nb * 32, nb * 32, seg * 11, 11, scr, nullptr, nullptr, 0, lane);
            continue; }
        r -= 512;
        { const int l = r / 32, nb = r % 32;
            conv_item(a.in(I_WOUT) + (size_t)l * 1024 * 1024, 1024, 1024, (bf16*)(a.ws() + WS_WTO) + (size_t)l * 1024 * 1024, nb * 32, nb * 32, 0, 16, scr, nullptr, nullptr, 0, lane); }
    }
    {
        const int gt = gw * 64 + lane, NGT = NGW * 64;
        bf16* WG = (bf16*)(a.ws() + WS_WG); bf16* WPL = (bf16*)(a.ws() + WS_WPL);
        const float* lgw = a.in(I_LGW); const float* pw = a.in(I_PW);
        for (int i = gt; i < 2 * 2 * 2 * 8 * 64 * 64; i += NGT) { const int m = i >> 12, cp = (i >> 6) & 63, cc = i & 63; WG[i] = (bf16)f2bf(lgw[(size_t)m * 4096 + cc * 64 + cp]); }
        for (int i = gt; i < 2 * 4 * 64 * 64; i += NGT) { const int m = i >> 12, dp = (i >> 6) & 63, cc = i & 63; WPL[i] = (bf16)f2bf(pw[(size_t)m * 4096 + cc * 64 + dp]); }
    }
    {
        bf16* XB = (bf16*)(a.ws() + WS_XB); float* SSQ = (float*)(a.ws() + WS_SSQ);
        const float* ng = a.in(I_NORMG);
        const float* xin = a.in(I_X); const float* cin = a.in(I_CTX);
        for (int row = gw; row < MROWS; row += NGW) {
            const float* xr = row < MLAT ? xin + (size_t)row * 1024 : cin + (size_t)(row - MLAT) * 1024;
            const int b = row < SEQ ? 0 : (row < MLAT ? 1 : 2);
            const float* scv = MOD + (size_t)b * 9216 + 1024;
            f32x4 v[4]; float s = 0.f;
#pragma unroll
            for (int j = 0; j < 4; ++j) { v[j] = ((const f32x4*)xr)[lane + 64 * j]; s += (v[j].x * v[j].x + v[j].y * v[j].y) + (v[j].z * v[j].z + v[j].w * v[j].w); }
            s = wave_sum(s);
#pragma unroll
            for (int j = 0; j < 4; ++j) { const int col = 4 * (lane + 64 * j); const f32x4 g = *(const f32x4*)(ng + col), sc = *(const f32x4*)(scv + col); const f32x4 o = v[j] * g * (sc + 1.0f);
                v2u w; w.x = pk2(o.x, o.y); w.y = pk2(o.z, o.w); *(v2u*)(XB + (size_t)row * 1024 + col) = w; }
            if (lane < 4) SSQ[(size_t)row * 4 + lane] = lane == 0 ? s : 0.f;
        }
    }
    for (int it = gw; it < 1024 + 64; it += NGW) {
        if (it < 1024) filt_item(a, 0, false, it >> 3, it & 7, lane);
        else { const int r = it - 1024; filt_item(a, r >> 5, true, (r >> 3) & 3, r & 7, lane); }
    }
}
template <int S> __device__ __forceinline__ void fft_pass_fwd(LAS float* re, LAS float* im, int tid) {
#pragma unroll 2
    for (int i = 0; i < 8; ++i) {
        const int b = tid + 512 * i, j = b & (S - 1), p0 = ((b - j) << 2) + j;
        const float x0r = re[p0], x0i = im[p0], x1r = re[p0 + S], x1i = im[p0 + S], x2r = re[p0 + 2 * S], x2i = im[p0 + 2 * S], x3r = re[p0 + 3 * S], x3i = im[p0 + 3 * S];
        const float s02r = x0r + x2r, s02i = x0i + x2i, d02r = x0r - x2r, d02i = x0i - x2i, s13r = x1r + x3r, s13i = x1i + x3i, d13r = x1r - x3r, d13i = x1i - x3i;
        float y0r = s02r + s13r, y0i = s02i + s13i, y2r = s02r - s13r, y2i = s02i - s13i;
        float y1r = d02r + d13i, y1i = d02i - d13r, y3r = d02r - d13i, y3i = d02i + d13r;
        if (S > 1) {
            const float f = (float)j * (1.0f / (4.0f * (float)S));
            const float c1 = __builtin_amdgcn_cosf(f), s1 = -__builtin_amdgcn_sinf(f);
            const float c2 = c1 * c1 - s1 * s1, s2 = 2.0f * c1 * s1, c3 = c1 * c2 - s1 * s2, s3 = c1 * s2 + s1 * c2;
            float t;
            t = y1r * c1 - y1i * s1; y1i = y1r * s1 + y1i * c1; y1r = t;
            t = y2r * c2 - y2i * s2; y2i = y2r * s2 + y2i * c2; y2r = t;
            t = y3r * c3 - y3i * s3; y3i = y3r * s3 + y3i * c3; y3r = t;
        }
        re[p0] = y0r; im[p0] = y0i; re[p0 + S] = y1r; im[p0 + S] = y1i; re[p0 + 2 * S] = y2r; im[p0 + 2 * S] = y2i; re[p0 + 3 * S] = y3r; im[p0 + 3 * S] = y3i;
    }
    __syncthreads();
}
template <int S> __device__ __forceinline__ void fft_pass_inv(LAS float* re, LAS float* im, int tid) {
#pragma unroll 2
    for (int i = 0; i < 8; ++i) {
        const int b = tid + 512 * i, j = b & (S - 1), p0 = ((b - j) << 2) + j;
        float t0r = re[p0], t0i = im[p0], t1r = re[p0 + S], t1i = im[p0 + S], t2r = re[p0 + 2 * S], t2i = im[p0 + 2 * S], t3r = re[p0 + 3 * S], t3i = im[p0 + 3 * S];
        if (S > 1) {
            const float f = (float)j * (1.0f / (4.0f * (float)S));
            const float c1 = __builtin_amdgcn_cosf(f), s1 = __builtin_amdgcn_sinf(f);
            const float c2 = c1 * c1 - s1 * s1, s2 = 2.0f * c1 * s1, c3 = c1 * c2 - s1 * s2, s3 = c1 * s2 + s1 * c2;
            float t;
            t = t1r * c1 - t1i * s1; t1i = t1r * s1 + t1i * c1; t1r = t;
            t = t2r * c2 - t2i * s2; t2i = t2r * s2 + t2i * c2; t2r = t;
            t = t3r * c3 - t3i * s3; t3i = t3r * s3 + t3i * c3; t3r = t;
        }
        const float s02r = t0r + t2r, s02i = t0i + t2i, d02r = t0r - t2r, d02i = t0i - t2i, s13r = t1r + t3r, s13i = t1i + t3i, d13r = t1r - t3r, d13i = t1i - t3i;
        re[p0] = s02r + s13r; im[p0] = s02i + s13i; re[p0 + 2 * S] = s02r - s13r; im[p0 + 2 * S] = s02i - s13i;
        re[p0 + S] = d02r - d13i; im[p0 + S] = d02i + d13r; re[p0 + 3 * S] = d02r + d13i; im[p0 + 3 * S] = d02i - d13r;
    }
    __syncthreads();
}
__device__ __forceinline__ void fft_fwd(LAS float* re, LAS float* im, int tid) {
    fft_pass_fwd<4096>(re, im, tid); fft_pass_fwd<1024>(re, im, tid); fft_pass_fwd<256>(re, im, tid); fft_pass_fwd<64>(re, im, tid); fft_pass_fwd<16>(re, im, tid); fft_pass_fwd<4>(re, im, tid); fft_pass_fwd<1>(re, im, tid);
}
__device__ __forceinline__ void fft_inv(LAS float* re, LAS float* im, int tid) {
    fft_pass_inv<1>(re, im, tid); fft_pass_inv<4>(re, im, tid); fft_pass_inv<16>(re, im, tid); fft_pass_inv<64>(re, im, tid); fft_pass_inv<256>(re, im, tid); fft_pass_inv<1024>(re, im, tid); fft_pass_inv<4096>(re, im, tid);
}
__device__ __forceinline__ float conv3(const float* row, int t, int n, float w0, float w1, float w2, float bias) {
    const float xm = t > 0 ? row[t - 1] : 0.f, x0 = row[t], xp = t + 1 < n ? row[t + 1] : 0.f;
    return bias + w0 * xm + w1 * x0 + w2 * xp;
}
__device__ __forceinline__ void hyena_unit(const Ctx& a, int l, int c, int slot, LAS unsigned char* lds, int tid) {
    LAS float* re = (LAS float*)lds; LAS float* im = re + 16384;
    const float* ZT = (const float*)(a.ws() + WS_ZT);
    const float* FILT = (const float*)(a.ws() + WS_FILT);
    float* KS = (float*)(a.ws() + WS_XB) + (size_t)slot * 32768;
    float* YCT = (float*)(a.ws() + WS_YCT);
    const float* hcw = a.in(I_HCW) + (size_t)l * 3 * 768; const float* hcb = a.in(I_HCB) + (size_t)l * 768; const float* hsk = a.in(I_HSKIP) + (size_t)l * 512;
    const float wv0 = hcw[c], wv1 = hcw[768 + c], wv2 = hcw[1536 + c], bv = hcb[c];
    const float wa0 = hcw[256 + c], wa1 = hcw[768 + 256 + c], wa2 = hcw[1536 + 256 + c], ba = hcb[256 + c];
    const float wb0 = hcw[512 + c], wb1 = hcw[768 + 512 + c], wb2 = hcw[1536 + 512 + c], bb = hcb[512 + c];
    const float sk0 = hsk[c], sk1 = hsk[256 + c];
    const float* rv = ZT + (size_t)c * MROWS; const float* r1 = ZT + (size_t)(256 + c) * MROWS; const float* r2 = ZT + (size_t)(512 + c) * MROWS;
    float* yrow = YCT + (size_t)c * MROWS;
#pragma unroll 1
    for (int o = 0; o < 2; ++o) {
        const float* ff = FILT + (size_t)((o * 2 + 0) * 256 + c) * 8192; const float* fb = FILT + (size_t)((o * 2 + 1) * 256 + c) * 8192;
#pragma unroll 4
        for (int i = 0; i < 32; ++i) { const int t = tid + 512 * i; const float v = t < 8192 ? ff[t] : (t == 8192 ? 0.f : fb[16384 - t]); re[t] = v; im[t] = 0.f; }
        __syncthreads();
        fft_fwd(re, im, tid);
#pragma unroll 4
        for (int i = 0; i < 32; ++i) { const int p = tid + 512 * i; KS[p] = re[p] * (1.0f / 16384.0f); KS[16384 + p] = im[p] * (1.0f / 16384.0f); }
        __syncthreads();
#pragma unroll 2
        for (int i = 0; i < 16; ++i) { const int t = tid + 512 * i;
            float v0, v1;
            if (o == 0) { v0 = conv3(rv, t, 8192, wv0, wv1, wv2, bv); v1 = conv3(rv + 8192, t, 8192, wv0, wv1, wv2, bv); } else { v0 = yrow[t]; v1 = yrow[8192 + t]; }
            re[t] = v0; im[t] = v1; re[8192 + t] = 0.f; im[8192 + t] = 0.f; }
        __syncthreads();
        fft_fwd(re, im, tid);
#pragma unroll 4
        for (int i = 0; i < 32; ++i) { const int p = tid + 512 * i; const float kr = KS[p], ki = KS[16384 + p], xr = re[p], xi = im[p]; re[p] = xr * kr - xi * ki; im[p] = xr * ki + xi * kr; }
        __syncthreads();
        fft_inv(re, im, tid);
#pragma unroll 2
        for (int i = 0; i < 16; ++i) { const int t = tid + 512 * i; const float cv0 = re[t], cv1 = im[t];
            if (o == 0) { const float v0 = conv3(rv, t, 8192, wv0, wv1, wv2, bv), v1 = conv3(rv + 8192, t, 8192, wv0, wv1, wv2, bv);
                const float a0 = conv3(r1, t, 8192, wa0, wa1, wa2, ba), a1 = conv3(r1 + 8192, t, 8192, wa0, wa1, wa2, ba);
                yrow[t] = a0 * (cv0 + sk0 * v0); yrow[8192 + t] = a1 * (cv1 + sk0 * v1); }
            else { const float b0 = conv3(r2, t, 8192, wb0, wb1, wb2, bb), b1 = conv3(r2 + 8192, t, 8192, wb0, wb1, wb2, bb);
                const float q0 = yrow[t], q1 = yrow[8192 + t];
                yrow[t] = b0 * (cv0 + sk1 * q0); yrow[8192 + t] = b1 * (cv1 + sk1 * q1); } }
        __syncthreads();
    }
    {
        LAS float* kf = (LAS float*)lds;
        LAS float* vv = kf + 1024;
        const float* FC = (const float*)(a.ws() + WS_FILTC) + (size_t)l * 1024 * 256;
        for (int i = tid; i < 1024; i += 512) kf[i] = FC[(size_t)((i >> 8) * 256 + c) * 256 + (i & 255)];
        const int b = tid >> 8, t = tid & 255;
        const int off = MLAT + b * 256;
        const float v = conv3(rv + off, t, 256, wv0, wv1, wv2, bv), x1 = conv3(r1 + off, t, 256, wa0, wa1, wa2, ba), x2 = conv3(r2 + off, t, 256, wb0, wb1, wb2, bb);
        vv[b * 256 + t] = v;
        __syncthreads();
        float s = 0.f;
        for (int q = 0; q < 256; ++q) { const int d = t - q; const float k = d >= 0 ? kf[d] : kf[256 - d]; s += k * vv[b * 256 + q]; }
        const float yy = x1 * (s + sk0 * v);
        __syncthreads();
        vv[b * 256 + t] = yy;
        __syncthreads();
        s = 0.f;
        for (int q = 0; q < 256; ++q) { const int d = t - q; const float k = d >= 0 ? kf[512 + d] : kf[768 - d]; s += k * vv[b * 256 + q]; }
        YCT[(size_t)c * MROWS + off + t] = x2 * (s + sk1 * yy);
        __syncthreads();
    }
}

template <bool APPLY> __device__ __forceinline__ void scan_unit(const Ctx& a, int l, int pm, int h, LAS unsigned char* lds, int tid) {
    const int wave = __builtin_amdgcn_readfirstlane(tid >> 6), lane = tid & 63, r32 = lane & 31, hh = lane >> 5;
    LAS float* uf = (LAS float*)lds;
    LAS bf16* ub = (LAS bf16*)(lds + 65536);
    LAS float* carryw = (LAS float*)(lds + 65536 + 36864);
    const int tok0 = pm * 256;
    const int seq_lo = pm < 64 ? (pm >> 5) * SEQ : tok0, seq_hi = pm < 64 ? seq_lo + SEQ : tok0 + 256;
    const float* XA = (const float*)(a.ws() + WS_XA);
    float* SUM = (float*)(a.ws() + WS_SUM); float* SUMW = (float*)(a.ws() + WS_SUMW);
    const float* cw = a.in(I_LCW) + (size_t)l * 4 * 512; const float* cb_ = a.in(I_LCB) + (size_t)l * 512;
    for (int i = tid; i < 256 * 16; i += 512) {
        const int t = i >> 4, q = i & 15, ch = h * 64 + 4 * q;
        f32x4 acc = *(const f32x4*)(cb_ + ch);
#pragma unroll
        for (int k = 0; k < 4; ++k) { const int row = tok0 + t + k - 2;
            if (row >= seq_lo && row < seq_hi) { const f32x4 x = *(const f32x4*)(XA + (size_t)row * 512 + ch), w = *(const f32x4*)(cw + k * 512 + ch); acc += w * x; } }
        *(LAS f32x4*)(uf + t * 64 + 4 * q) = acc;
        v2u pk; pk.x = pk2(acc.x, acc.y); pk.y = pk2(acc.z, acc.w); *(LAS v2u*)(ub + t * 72 + 4 * q) = pk;
    }
    if (APPLY) {
        if (tid < 128) {
            const int d = tid >> 6, cp = tid & 63, ch = h * 64 + cp;
            float H = 0.f;
            if (pm < 64) {
                const int bb = pm >> 5, cpm = 64 + bb;
                H = SUM[((size_t)(cpm * 2 + d) * 2 + 1) * 512 + ch];
                if (d == 0) { for (int j = bb * 32; j < pm; ++j) H = SUM[((size_t)(j * 2 + 0) * 2 + 0) * 512 + ch] * H + SUM[((size_t)(j * 2 + 0) * 2 + 1) * 512 + ch]; }
                else { for (int j = bb * 32 + 31; j > pm; --j) H = SUM[((size_t)(j * 2 + 1) * 2 + 0) * 512 + ch] * H + SUM[((size_t)(j * 2 + 1) * 2 + 1) * 512 + ch]; }
            }
            if (d == 0) { for (int w = 0; w < 8; ++w) { carryw[(w * 2 + 0) * 64 + cp] = H; const size_t s = ((size_t)((pm * 8 + w) * 2 + 0) * 2) * 512 + ch; H = SUMW[s] * H + SUMW[s + 512]; } }
            else { for (int w = 7; w >= 0; --w) { carryw[(w * 2 + 1) * 64 + cp] = H; const size_t s = ((size_t)((pm * 8 + w) * 2 + 1) * 2) * 512 + ch; H = SUMW[s] * H + SUMW[s + 512]; } }
        }
    }
    __syncthreads();
    const int t0 = wave * 32;
    bf16x8 A[4];
#pragma unroll
    for (int ks = 0; ks < 4; ++ks) A[ks] = *(const LAS bf16x8*)(ub + (t0 + r32) * 72 + 16 * ks + 8 * hh);
    const bf16* WG = (const bf16*)(a.ws() + WS_WG);
    const float* gb = a.in(I_LGB) + (size_t)l * 4 * 512; const float* lam = a.in(I_LLAM) + (size_t)l * 2 * 512;
#pragma unroll 1
    for (int cb = 0; cb < 2; ++cb) {
        const int cp = cb * 32 + r32, ch = h * 64 + cp;
        float hs[16];
#pragma unroll
        for (int r = 0; r < 16; ++r) hs[r] = 0.f;
#pragma unroll
        for (int d = 0; d < 2; ++d) {
            f32x16 ar, ai;
#pragma unroll
            for (int r = 0; r < 16; ++r) { ar[r] = 0.f; ai[r] = 0.f; }
            const bf16* Br = WG + ((size_t)(((l * 2 + d) * 2 + 0) * 8 + h) * 64 + cp) * 64 + 8 * hh;
            const bf16* Bi = WG + ((size_t)(((l * 2 + d) * 2 + 1) * 8 + h) * 64 + cp) * 64 + 8 * hh;
#pragma unroll
            for (int ks = 0; ks < 4; ++ks) { const bf16x8 br = *(const bf16x8*)(Br + 16 * ks), bi = *(const bf16x8*)(Bi + 16 * ks);
                ar = __builtin_amdgcn_mfma_f32_32x32x16_bf16(A[ks], br, ar, 0, 0, 0); ai = __builtin_amdgcn_mfma_f32_32x32x16_bf16(A[ks], bi, ai, 0, 0, 0); }
            const float bgr = gb[(d * 2 + 0) * 512 + ch], bgi = gb[(d * 2 + 1) * 512 + ch];
            const float lm = lam[d * 512 + ch];
            const float sp = lm > 15.f ? expf(-lm) : log1pf(expf(-lm));
            float av[16], bx[16];
#pragma unroll
            for (int r = 0; r < 16; ++r) { const int t = t0 + (r & 3) + 8 * (r >> 2) + 4 * hh;
                const float rg = sigmoid_f(ar[r] + bgr), ig = sigmoid_f(ai[r] + bgi);
                const float la = -8.0f * rg * sp;
                av[r] = expf(la); bx[r] = sqrtf(-expm1f(2.0f * la)) * (ig * uf[t * 64 + cp]); }
            float P[4], E[4];
#pragma unroll
            for (int q = 0; q < 4; ++q) { float p = 1.f, e = 0.f;
                if (d == 0) {
#pragma unroll
                    for (int j = 0; j < 4; ++j) { e = av[4 * q + j] * e + bx[4 * q + j]; p *= av[4 * q + j]; } }
                else {
#pragma unroll
                    for (int j = 3; j >= 0; --j) { e = av[4 * q + j] * e + bx[4 * q + j]; p *= av[4 * q + j]; } }
                P[q] = p; E[q] = e; }
            float RP[8], RE[8];
#pragma unroll
            for (int q = 0; q < 4; ++q) { const float pp = __shfl_xor(P[q], 32), ep = __shfl_xor(E[q], 32);
                RP[2 * q] = hh == 0 ? P[q] : pp; RE[2 * q] = hh == 0 ? E[q] : ep; RP[2 * q + 1] = hh == 0 ? pp : P[q]; RE[2 * q + 1] = hh == 0 ? ep : E[q]; }
            if (!APPLY) {
                float wp = 1.f, we = 0.f;
                if (d == 0) {
#pragma unroll
                    for (int rho = 0; rho < 8; ++rho) { we = RP[rho] * we + RE[rho]; wp *= RP[rho]; } }
                else {
#pragma unroll
                    for (int rho = 7; rho >= 0; --rho) { we = RP[rho] * we + RE[rho]; wp *= RP[rho]; } }
                if (hh == 0) { const size_t s = ((size_t)((pm * 8 + wave) * 2 + d) * 2) * 512 + ch; SUMW[s] = wp; SUMW[s + 512] = we;
                    carryw[((wave * 2 + d) * 2 + 0) * 64 + cp] = wp; carryw[((wave * 2 + d) * 2 + 1) * 64 + cp] = we; }
            } else {
                float Hc = carryw[(wave * 2 + d) * 64 + cp];
                if (d == 0) {
#pragma unroll
                    for (int rho = 0; rho < 8; ++rho) {
                        if ((rho & 1) == hh) { float hcur = Hc; const int q = rho >> 1;
#pragma unroll
                            for (int j = 0; j < 4; ++j) { hcur = av[4 * q + j] * hcur + bx[4 * q + j]; hs[4 * q + j] += hcur; } }
                        Hc = RP[rho] * Hc + RE[rho]; }
                } else {
#pragma unroll
                    for (int rho = 7; rho >= 0; --rho) {
                        if ((rho & 1) == hh) { float hcur = Hc; const int q = rho >> 1;
#pragma unroll
                            for (int j = 3; j >= 0; --j) { hcur = av[4 * q + j] * hcur + bx[4 * q + j]; hs[4 * q + j] += hcur; } }
                        Hc = RP[rho] * Hc + RE[rho]; }
                }
            }
        }
        if (APPLY) {
            const bf16* GA = (const bf16*)(a.ws() + WS_GA); bf16* YC = (bf16*)(a.ws() + WS_YC);
#pragma unroll
            for (int r = 0; r < 16; ++r) { const int row = tok0 + t0 + (r & 3) + 8 * (r >> 2) + 4 * hh;
                const float g = bf2f((unsigned)GA[(size_t)row * 512 + ch]);
                YC[(size_t)row * 1024 + ch] = (bf16)f2bf(hs[r] * gelu_tanh_f(g)); }
        }
    }
    __syncthreads();
    if (!APPLY) {
        if (tid < 128) { const int d = tid >> 6, cp = tid & 63, ch = h * 64 + cp; float p = 1.f, e = 0.f;
            if (d == 0) { for (int w = 0; w < 8; ++w) { const float wp = carryw[((w * 2 + 0) * 2 + 0) * 64 + cp], we = carryw[((w * 2 + 0) * 2 + 1) * 64 + cp]; e = wp * e + we; p *= wp; } }
            else { for (int w = 7; w >= 0; --w) { const float wp = carryw[((w * 2 + 1) * 2 + 0) * 64 + cp], we = carryw[((w * 2 + 1) * 2 + 1) * 64 + cp]; e = wp * e + we; p *= wp; } }
            SUM[((size_t)(pm * 2 + d) * 2 + 0) * 512 + ch] = p; SUM[((size_t)(pm * 2 + d) * 2 + 1) * 512 + ch] = e; }
        __syncthreads();
    }
}

__device__ __forceinline__ void pool_unit(const Ctx& a, int l, int pm, int g, LAS unsigned char* lds, int tid) {
    const int wave = __builtin_amdgcn_readfirstlane(tid >> 6), lane = tid & 63, r32 = lane & 31, hh = lane >> 5;
    LAS float* pf = (LAS float*)lds;
    LAS bf16* pb = (LAS bf16*)(lds + 65536);
    const bf16* UP = (const bf16*)(a.ws() + WS_UP); bf16* YC = (bf16*)(a.ws() + WS_YC);
    const int tok0 = pm * 256;
    for (int i = tid; i < 256 * 8; i += 512) { const int t = i >> 3, q = i & 7;
        const v4u w = *(const v4u*)(UP + (size_t)(tok0 + t) * 256 + g * 64 + 8 * q);
        LAS float* d = pf + t * 64 + 8 * q;
        d[0] = bf2f(w.x & 0xffffu); d[1] = bf2f(w.x >> 16); d[2] = bf2f(w.y & 0xffffu); d[3] = bf2f(w.y >> 16); d[4] = bf2f(w.z & 0xffffu); d[5] = bf2f(w.z >> 16); d[6] = bf2f(w.w & 0xffffu); d[7] = bf2f(w.w >> 16); }
    __syncthreads();
    const int win = 2 << g, n = pm < 64 ? 64 : 256;
    for (int i = tid; i < 256 * 64; i += 512) { const int t = i >> 6, cc = i & 63;
        const int pos = pm < 64 ? (t & 63) : t, base = t - pos;
        const int lo = pos - win / 2 < 0 ? 0 : pos - win / 2, hi = pos + win - win / 2 > n ? n : pos + win - win / 2;
        float s = 0.f;
        for (int q = lo; q < hi; ++q) s += pf[(base + q) * 64 + cc];
        const float pooled = s / (float)(hi - lo) - pf[t * 64 + cc];
        pb[t * 72 + cc] = (bf16)f2bf(pooled); }
    __syncthreads();
    const int t0 = wave * 32;
    bf16x8 A[4];
#pragma unroll
    for (int ks = 0; ks < 4; ++ks) A[ks] = *(const LAS bf16x8*)(pb + (t0 + r32) * 72 + 16 * ks + 8 * hh);
    const bf16* WPL = (const bf16*)(a.ws() + WS_WPL) + (size_t)(l * 4 + g) * 4096;
    const float* pbp = a.in(I_PB); const float* psp = a.in(I_PS);
#pragma unroll
    for (int cb = 0; cb < 2; ++cb) {
        const int dp = cb * 32 + r32, dch = g * 64 + dp;
        f32x16 acc;
#pragma unroll
        for (int r = 0; r < 16; ++r) acc[r] = 0.f;
#pragma unroll
        for (int ks = 0; ks < 4; ++ks) { const bf16x8 bw = *(const bf16x8*)(WPL + (size_t)dp * 64 + 16 * ks + 8 * hh); acc = __builtin_amdgcn_mfma_f32_32x32x16_bf16(A[ks], bw, acc, 0, 0, 0); }
        const float pbias = pbp[l * 256 + dch], psc = psp[l * 256 + dch];
#pragma unroll
        for (int r = 0; r < 16; ++r) { const int row = tok0 + t0 + (r & 3) + 8 * (r >> 2) + 4 * hh;
            YC[(size_t)row * 1024 + 512 + dch] = (bf16)f2bf((acc[r] + pbias) * psc); }
    }
    __syncthreads();
}

__device__ __forceinline__ void ytr_item(const Ctx& a, int tb, int cbk, LAS float* scr, int lane) {
    const float* YCT = (const float*)(a.ws() + WS_YCT); bf16* YC = (bf16*)(a.ws() + WS_YC);
#pragma unroll 8
    for (int i = 0; i < 32; ++i) scr[i * 65 + lane] = YCT[(size_t)(cbk * 32 + i) * MROWS + tb * 64 + lane];
    LDS_WAIT(); asm volatile("" ::: "memory");
#pragma unroll
    for (int j = 0; j < 4; ++j) { const int tok = (lane >> 2) + 16 * j, q = lane & 3; const LAS float* s = scr + (8 * q) * 65 + tok;
        v4u o; o.x = pk2(s[0], s[65]); o.y = pk2(s[130], s[195]); o.z = pk2(s[260], s[325]); o.w = pk2(s[390], s[455]);
        *(v4u*)(YC + (size_t)(tb * 64 + tok) * 1024 + 768 + cbk * 32 + 8 * q) = o; }
    LDS_WAIT(); asm volatile("" ::: "memory");
}
__global__ void __launch_bounds__(NWAVES * 64, 2) fwd_kernel(Args ka) {
    extern __shared__ __attribute__((aligned(16))) unsigned char lds_raw[];
    LAS unsigned char* lds = (LAS unsigned char*)lds_raw;
    volatile LAS unsigned* MISC = (volatile LAS unsigned*)(lds + MISC_OFF);
    const int tid = threadIdx.x, lane = tid & 63, wave = __builtin_amdgcn_readfirstlane(tid >> 6);
    const int G = gridDim.x, bid = blockIdx.x;
    const int vcu = (G % 8 == 0) ? (bid % 8) * (G / 8) + bid / 8 : bid;
    for (int u = tid; u < (LDS_BYTES - LDSCTL_OFF) / 4; u += NWAVES * 64) ((LAS unsigned*)(lds + LDSCTL_OFF))[u] = 0u;
    __syncthreads();
    Ctx a; a.T = (volatile LAS unsigned long long*)(lds + ARGS_OFF);
    if (tid == 0) {
#pragma unroll
        for (int i = 0; i < 29; ++i) a.T[i] = (unsigned long long)ka.in[i];
        a.T[29] = (unsigned long long)ka.out; a.T[30] = (unsigned long long)ka.ws;
    }
    __syncthreads();
    (void)xcd_barrier_post((unsigned*)(ka.ws + WS_CTL) + CW_BAR, MISC + 8);
    LAS float* red = (LAS float*)(lds + RED_OFF);
#define GRID_BAR() do { XcdBarrier b_; b_.bar = (unsigned*)(a.ws() + WS_CTL) + CW_BAR; b_.x = xb_xcc_id(); b_.st = MISC + 8; xcd_barrier(b_); } while (0)
    const int gw = vcu * NWAVES + wave, NGW = G * NWAVES;

    phase_p0a(a, lds, tid, vcu, G);
    GRID_BAR();
    phase_p0b(a, lds, tid, vcu, G);
    GRID_BAR();

#pragma unroll 1
    for (int l = 0; l < 2; ++l) {
#pragma unroll 1
        for (int f = 0; f < 2; ++f) {
            if (f == 1) {
                { unsigned char* ws = a.ws();
                  pg8::Gemm g{(const bf16*)(ws + WS_XB), (const bf16*)(ws + WS_WTP) + (size_t)l * DIN * 1024, MROWS, DIN, 1024}; pg8::StaticOrder S; S.init(MROWS, DIN, G, bid);
                  pg8::EpiProj E{(float*)(ws + WS_XA), (bf16*)(ws + WS_GA), (bf16*)(ws + WS_UP), (float*)(ws + WS_ZT), (const float*)(ws + WS_SSQ), (const float*)(ws + WS_BIAS) + (size_t)(l * 3 + 1) * 3 * 5632};
                  pg8::gemm_phase<pg8::EpiProj, pg8::StaticOrder, true, true>(lds, g, S, E); }
                GRID_BAR();
                { int t1 = tid; asm volatile("" : "+v"(t1)); for (int u = bid; u < 256; u += G) hyena_unit(a, l, u, bid, lds, t1); }
                { int t1 = tid; asm volatile("" : "+v"(t1)); for (int u = bid; u < NPANEL * 8; u += G) scan_unit<false>(a, l, u >> 3, u & 7, lds, t1); }
                { int t1 = tid; asm volatile("" : "+v"(t1)); for (int u = bid; u < NPANEL * 4; u += G) pool_unit(a, l, u >> 2, u & 3, lds, t1); }
                GRID_BAR();
                { int t1 = tid; asm volatile("" : "+v"(t1)); for (int u = bid; u < NPANEL * 8; u += G) scan_unit<true>(a, l, u >> 3, u & 7, lds, t1); }
                { int l1 = lane; asm volatile("" : "+v"(l1)); LAS float* scr = (LAS float*)(lds + wave * 16384);
                  for (int it = gw; it < (MROWS / 64) * 8; it += NGW) ytr_item(a, it >> 3, it & 7, scr, l1);
                  if (l == 0) for (int it = gw; it < 1024; it += NGW) filt_item(a, 1, false, it >> 3, it & 7, l1); }
                GRID_BAR();
                { unsigned char* ws = a.ws(); float* xl = a.out(); float* XC = (float*)(ws + WS_XC);
                  const float* modl = (const float*)(ws + WS_MOD) + (size_t)l * 3 * 9216; const float* ngl = a.in(I_NORMG) + (size_t)l * 3 * 1024;
                  pg8::Gemm g{(const bf16*)(ws + WS_YC), (const bf16*)(ws + WS_WTO) + (size_t)l * 1024 * 1024, MROWS, 1024, 1024}; pg8::StaticOrder S; S.init(MROWS, 1024, G, bid);
                  pg8::EpiResid<false> E{xl, XC, xl, XC, (bf16*)(ws + WS_XB), (float*)(ws + WS_SSQ), modl + 5 * 1024, ngl + 2 * 1024, modl + 7 * 1024, red};
                  pg8::gemm_phase<pg8::EpiResid<false>, pg8::StaticOrder, true, true>(lds, g, S, E); }
                GRID_BAR();
            }
            { unsigned char* ws = a.ws();
              pg8::Gemm g{(const bf16*)(ws + WS_XB), (const bf16*)(ws + WS_WT1) + (size_t)(l * 2 + f) * NFF * 1024, MROWS, NFF, 1024}; pg8::StaticOrder S; S.init(MROWS, NFF, G, bid);
              pg8::EpiFfnIn E{(bf16*)(ws + WS_ACT), (const float*)(ws + WS_SSQ), (const float*)(ws + WS_BIAS) + (size_t)(l * 3 + (f == 0 ? 0 : 2)) * 3 * 5632};
              pg8::gemm_phase<pg8::EpiFfnIn, pg8::StaticOrder, true, true>(lds, g, S, E); }
            GRID_BAR();
            { unsigned char* ws = a.ws(); float* xl = a.out(); float* XC = (float*)(ws + WS_XC); const float* MOD = (const float*)(ws + WS_MOD);
              const float* modl = MOD + (size_t)l * 3 * 9216; const float* ngl = a.in(I_NORMG) + (size_t)l * 3 * 1024;
              pg8::Gemm g{(const bf16*)(ws + WS_ACT), (const bf16*)(ws + WS_WT2) + (size_t)(l * 2 + f) * 1024 * DFF, MROWS, 1024, DFF}; pg8::StaticOrder S; S.init(MROWS, 1024, G, bid);
              const bool first = (l == 0 && f == 0);
              const float* gn = f == 0 ? ngl + 1 * 1024 : (l == 0 ? ngl + (size_t)3 * 1024 : nullptr);
              const float* scn = f == 0 ? modl + 4 * 1024 : MOD + (size_t)3 * 9216 + 1 * 1024;
              pg8::EpiResid<true> E{first ? a.in(I_X) : xl, first ? a.in(I_CTX) : XC, xl, XC, (bf16*)(ws + WS_XB), (float*)(ws + WS_SSQ), modl + (f == 0 ? 2 : 8) * 1024, gn, scn, red};
              pg8::gemm_phase<pg8::EpiResid<true>, pg8::StaticOrder, true, true>(lds, g, S, E); }
            GRID_BAR();
        }
    }
    {
        const float* fg = a.in(I_FINALG); const float* SSQ = (const float*)(a.ws() + WS_SSQ); float* xo = a.out();
        for (int row = gw; row < MLAT; row += NGW) {
            const float rs = pg8::rstd_row(SSQ, row);
            f32x4* xr = (f32x4*)(xo + (size_t)row * 1024);
#pragma unroll
            for (int j = 0; j < 4; ++j) { const f32x4 v = xr[lane + 64 * j], g = ((const f32x4*)fg)[lane + 64 * j]; xr[lane + 64 * j] = v * rs * g; }
        }
    }
}

extern "C" void kernel_launch(void* const* d_in, const int* in_sizes, int n_in, void* d_out, int out_size, void* d_ws, size_t ws_size, hipStream_t stream) {
    static int grid = 0;
    if (grid == 0) {
        if (n_in != N_INPUTS || in_sizes[0] != MLAT * DM || out_size != MLAT * DM || ws_size < WS_END) {
            fprintf(stderr, "kernel_launch: unexpected problem (n_in %d, in0 %d, out %d, ws %zu; need ws >= %zu); nothing launched\n", n_in, n_in > 0 ? in_sizes[0] : -1, out_size, ws_size, (size_t)WS_END); grid = -1; return; }
        int dev = 0, cus = 0, per_cu = 0;
        if (hipGetDevice(&dev) != hipSuccess || hipDeviceGetAttribute(&cus, hipDeviceAttributeMultiprocessorCount, dev) != hipSuccess) { fprintf(stderr, "kernel_launch: device query failed\n"); grid = -1; return; }
        if (hipFuncSetAttribute((const void*)fwd_kernel, hipFuncAttributeMaxDynamicSharedMemorySize, LDS_BYTES) != hipSuccess) { fprintf(stderr, "kernel_launch: hipFuncSetAttribute failed\n"); grid = -1; return; }
        if (hipOccupancyMaxActiveBlocksPerMultiprocessor(&per_cu, (const void*)fwd_kernel, NWAVES * 64, LDS_BYTES) != hipSuccess || per_cu < 1)
            fprintf(stderr, "kernel_launch: note: occupancy query reports %d workgroups per CU\n", per_cu);
        (void)hipGetLastError();
        grid = cus;
    }
    if (grid < 0) return;
    if (hipMemsetAsync((char*)d_ws + WS_CTL, 0, CTL_ZERO_BYTES, stream) != hipSuccess) { fprintf(stderr, "kernel_launch: memset failed\n"); return; }
    Args a{};
    for (int i = 0; i < N_INPUTS; ++i) a.in[i] = (const float*)d_in[i];
    a.out = (float*)d_out; a.ws = (unsigned char*)d_ws;
    hipLaunchKernelGGL(fwd_kernel, dim3(grid), dim3(NWAVES * 64), LDS_BYTES, stream, a);
    const hipError_t le = hipPeekAtLastError();
    if (le != hipSuccess) fprintf(stderr, "kernel_launch: launch failed: %s\n", hipGetErrorName(le));
}
```
